# Optimizing an MI355X kernel written in HIP

```python
import jax, jax.numpy as jnp
from jax import lax
import numpy as np

D_MODEL = 1024
BATCH = 32
SEQ = 2048
DEPTH = 1

HEAD_DIM = 64
N_HEADS_A = 8
N_KV_A = 2
GROUP_A = N_HEADS_A // N_KV_A
N_HEADS_B = 8
WIDTH_A = N_HEADS_A * HEAD_DIM
KV_WIDTH_A = N_KV_A * HEAD_DIM
WIDTH_B = N_HEADS_B * HEAD_DIM
MIX_WIDTH = WIDTH_A + WIDTH_B
IN_COLS = WIDTH_A + 2 * KV_WIDTH_A + 3 * WIDTH_B
SPLITS = (WIDTH_A, WIDTH_A + KV_WIDTH_A, WIDTH_A + 2 * KV_WIDTH_A,
          WIDTH_A + 2 * KV_WIDTH_A + WIDTH_B, WIDTH_A + 2 * KV_WIDTH_A + 2 * WIDTH_B)
WINDOW = 128
BLOCK = 128
N_META = 16
PAD = BLOCK - N_META
D_FF = -(-8 * D_MODEL // (3 * 256)) * 256
ROPE_THETA = 10000.0
EPS = 1e-6

kernel_name = "hymba_swa_sink_stickbreaking_block"


def rmsnorm(x, g):
    xf = x.astype(jnp.float32)
    y = xf * lax.rsqrt(jnp.mean(xf * xf, axis=-1, keepdims=True) + EPS)
    return (y * g.astype(jnp.float32)).astype(x.dtype)


def rope(x, pos):
    half = HEAD_DIM // 2
    inv_freq = ROPE_THETA ** (-jnp.arange(half, dtype=jnp.float32) / half)
    ang = pos.astype(jnp.float32)[:, None] * inv_freq[None, :]
    cos = jnp.cos(ang)[None, :, None, :]
    sin = jnp.sin(ang)[None, :, None, :]
    xf = x.astype(jnp.float32)
    x1, x2 = xf[..., :half], xf[..., half:]
    return jnp.concatenate([x1 * cos - x2 * sin, x2 * cos + x1 * sin], axis=-1).astype(x.dtype)


def swa_sink_attention(q, k, v, sinks):
    B, P = q.shape[0], q.shape[1]
    nb = P // BLOCK
    qb = q.reshape(B, nb, BLOCK, N_KV_A, GROUP_A, HEAD_DIM)
    kb = k.reshape(B, nb, BLOCK, N_KV_A, HEAD_DIM)
    vb = v.reshape(B, nb, BLOCK, N_KV_A, HEAD_DIM)

    def with_context(t):
        meta = jnp.broadcast_to(t[:, :1, PAD:BLOCK], (B, nb, N_META, N_KV_A, HEAD_DIM))
        prev = jnp.concatenate([jnp.zeros_like(t[:, :1]), t[:, :-1]], axis=1)
        return jnp.concatenate([meta, prev, t], axis=2)

    kc, vc = with_context(kb), with_context(vb)
    blk = jnp.arange(nb)[:, None]
    ar = jnp.arange(BLOCK)[None, :]
    qpos = blk * BLOCK + ar
    kpos = jnp.concatenate([
        jnp.broadcast_to(jnp.arange(PAD, BLOCK)[None, :], (nb, N_META)),
        (blk - 1) * BLOCK + ar,
        blk * BLOCK + ar], axis=1)
    nk = kpos.shape[1]
    dist = qpos[:, :, None] - kpos[:, None, :]
    in_meta_seg = (jnp.arange(nk) < N_META)[None, None, :]
    band = (kpos[:, None, :] >= PAD) & (dist >= 0) & (dist < WINDOW)
    mask = jnp.where(in_meta_seg, dist >= WINDOW, band)

    s = jnp.einsum('bnqhgd,bnkhd->bnhgqk', qb, kc).astype(jnp.float32) * (HEAD_DIM ** -0.5)
    s = jnp.where(mask[None, :, None, None], s, -jnp.inf)
    sink = sinks.astype(jnp.float32).reshape(N_KV_A, GROUP_A)[None, None, :, :, None, None]
    m = jnp.maximum(jnp.max(s, axis=-1, keepdims=True), sink)
    p = jnp.exp(s - m)
    denom = jnp.sum(p, axis=-1, keepdims=True) + jnp.exp(sink - m)
    p = (p / denom).astype(v.dtype)
    o = jnp.einsum('bnhgqk,bnkhd->bnqhgd', p, vc)
    return o.reshape(B, P, WIDTH_A)


def stick_breaking_attention(q, k, v):
    B, P = q.shape[0], q.shape[1]
    nb = P // BLOCK
    qb = q.reshape(B, nb, BLOCK, N_HEADS_B, HEAD_DIM).transpose(1, 0, 3, 2, 4)
    kt = k.transpose(0, 2, 1, 3)
    vt = v.transpose(0, 2, 1, 3)
    kpos = jnp.arange(P)
    scale = HEAD_DIM ** -0.5

    def one_block(args):
        q_blk, i = args
        qpos = i * BLOCK + jnp.arange(BLOCK)
        mask = (kpos[None, :] >= PAD) & (kpos[None, :] < qpos[:, None])
        z = jnp.einsum('bhqd,bhkd->bhqk', q_blk, kt).astype(jnp.float32) * scale
        log_1m_beta = jnp.where(mask, -jax.nn.softplus(z), 0.0)
        later = lax.cumsum(log_1m_beta, axis=3, reverse=True) - log_1m_beta
        a = jnp.where(mask, jnp.exp(-jax.nn.softplus(-z) + later), 0.0)
        return jnp.einsum('bhqk,bhkd->bhqd', a.astype(v.dtype), vt)

    o = lax.map(one_block, (qb, jnp.arange(nb)))
    return o.transpose(1, 0, 3, 2, 4).reshape(B, P, WIDTH_B)


def setup_inputs(seed: int = 0) -> dict:
    key = jax.random.key(seed)
    ks = jax.random.split(key, 16)
    f32 = jnp.float32

    def gain(k, shape):
        return 1.0 + 0.02 * jax.random.normal(k, shape, f32)

    return {
        "x": jax.random.normal(ks[0], (BATCH, SEQ, D_MODEL), f32),
        "meta_tokens": jax.random.normal(ks[1], (N_META, D_MODEL), f32),
        "norm_mix": gain(ks[2], (DEPTH, D_MODEL)),
        "w_in": jax.random.normal(ks[3], (DEPTH, D_MODEL, IN_COLS), f32) * D_MODEL ** -0.5,
        "sinks": 0.5 * jax.random.normal(ks[4], (DEPTH, N_HEADS_A), f32),
        "norm_out_a": gain(ks[5], (DEPTH, WIDTH_A)),
        "norm_out_b": gain(ks[6], (DEPTH, WIDTH_B)),
        "w_out": jax.random.normal(ks[7], (DEPTH, MIX_WIDTH, D_MODEL), f32) * MIX_WIDTH ** -0.5,
        "norm_ffn": gain(ks[8], (DEPTH, D_MODEL)),
        "w_gate": jax.random.normal(ks[9], (DEPTH, D_MODEL, D_FF), f32) * D_MODEL ** -0.5,
        "w_up": jax.random.normal(ks[10], (DEPTH, D_MODEL, D_FF), f32) * D_MODEL ** -0.5,
        "w_down": jax.random.normal(ks[11], (DEPTH, D_FF, D_MODEL), f32) * D_FF ** -0.5,
        "norm_final": gain(ks[12], (D_MODEL,)),
    }


def reference(x, meta_tokens, norm_mix, w_in, sinks, norm_out_a, norm_out_b, w_out,
              norm_ffn, w_gate, w_up, w_down, norm_final):
    B = x.shape[0]
    pad = jnp.zeros((B, PAD, D_MODEL), x.dtype)
    meta = jnp.broadcast_to(meta_tokens.astype(x.dtype)[None], (B, N_META, D_MODEL))
    h = jnp.concatenate([pad, meta, x], axis=1)
    P = h.shape[1]
    pos = jnp.arange(P) - PAD

    for l in range(DEPTH):
        u = rmsnorm(h, norm_mix[l])
        proj = u @ w_in[l]
        qa, ka, va, qb, kb, vb = jnp.split(proj, SPLITS, axis=-1)
        qa = rope(qa.reshape(B, P, N_HEADS_A, HEAD_DIM), pos)
        ka = rope(ka.reshape(B, P, N_KV_A, HEAD_DIM), pos)
        va = va.reshape(B, P, N_KV_A, HEAD_DIM)
        oa = swa_sink_attention(qa, ka, va, sinks[l])
        ob = stick_breaking_attention(
            qb.reshape(B, P, N_HEADS_B, HEAD_DIM),
            kb.reshape(B, P, N_HEADS_B, HEAD_DIM),
            vb.reshape(B, P, N_HEADS_B, HEAD_DIM))
        mixed = jnp.concatenate([rmsnorm(oa, norm_out_a[l]), rmsnorm(ob, norm_out_b[l])], axis=-1)
        h = h + mixed @ w_out[l]
        u = rmsnorm(h, norm_ffn[l])
        h = h + (jax.nn.silu(u @ w_gate[l]) * (u @ w_up[l])) @ w_down[l]

    return rmsnorm(h, norm_final)[:, BLOCK:]
```

```cpp
#include <hip/hip_runtime.h>
#include <hip/hip_cooperative_groups.h>
#include <cstdio>
#include <cstdint>
namespace cg = cooperative_groups;
namespace pg8 {
#define PG8_LAS __attribute__((address_space(3)))
typedef unsigned short bf16_t;
typedef short bf16x8 __attribute__((ext_vector_type(8)));
typedef float f32x4 __attribute__((ext_vector_type(4)));
typedef unsigned u32x4 __attribute__((ext_vector_type(4)));
constexpr int BM = 256, BK = 64, HALF = 128, HTB = HALF * BK * 2  , STAGE_BYTES = 8 * HTB, NXCD = 8, WGM = 8;

__host__ __device__ __forceinline__ int lds_byte(int r, int c) { const int st = (r >> 4) * 2 + (c >> 5), rr = r & 15, cc = c & 31, ob = rr * 64 + cc * 2; return st * 1024 + (ob ^ (((ob >> 9) & 1) << 5)); }
__host__ __device__ __forceinline__ void stage_rc(int b, int& R, int& C) { const int st = b / 1024, sb = b % 1024, swz = sb ^ (((sb >> 9) & 1) << 5); R = (st >> 1) * 16 + swz / 64; C = (st & 1) * 32 + (swz % 64) / 2; }
__host__ __device__ __forceinline__ int perm32(int rho) { const int n = rho >> 4, i = rho & 15; return 8 * (i >> 2) + 4 * n + (i & 3); }

struct Unit { int pm, pn; };
struct Gemm { const bf16_t* A; const bf16_t* Bt; int M, N, K; };

struct StaticOrder {
    int nM, nN, nwg, G, c;
    __host__ __device__ void init(int M, int N, int G_, int c_) { nM = M / BM; nN = N / BM; nwg = nM * nN; G = G_; c = c_; }
    __host__ __device__ bool next(int i, Unit& u) const {
        const long L = (long)i * G + c; if (L >= nwg) return false;
        int wgid = (int)L; { const int q = nwg / NXCD, r = nwg % NXCD, xcd = wgid % NXCD, off = wgid / NXCD; wgid = (xcd < r ? xcd * (q + 1) : r * (q + 1) + (xcd - r) * q) + off; }
        const int nig = WGM * nN, gid = wgid / nig, fm = gid * WGM, gsz = (nM - fm) < WGM ? (nM - fm) : WGM;
        u.pm = fm + ((wgid % nig) % gsz); u.pn = (wgid % nig) / gsz; return true;
    }
    __device__ __forceinline__ void a_ready(const Unit&) const {}
    __device__ __forceinline__ void done(const Unit&) const {}
};

__device__ __forceinline__ unsigned cvt_pk_bf16(float lo, float hi) { unsigned r; asm volatile("v_cvt_pk_bf16_f32 %0, %1, %2" : "=v"(r) : "v"(lo), "v"(hi)); return r; }
typedef float f32x2 __attribute__((ext_vector_type(2)));
typedef unsigned u32x2 __attribute__((ext_vector_type(2)));
constexpr int PROJ_LD = 2304, P_ROWS = 2176;
constexpr float QSCALE = 0.125f * 1.4426950408889634f;
struct EpiProj {
    static constexpr bool PERM = true, AFTER_DRAIN = false;
    bf16_t* O;
    __device__ __forceinline__ void operator()(const f32x4 (&acc)[2][2][4][2], const Unit& u, int wr, int wc, int fr, int fq) const {
        const int b = u.pm >> 3, t0 = (u.pm & 7) * 256 + wr * 64 + fr;
        bf16_t* obase = O + ((size_t)b * P_ROWS + 128 + t0) * PROJ_LD;
#pragma unroll
        for (int bj = 0; bj < 2; ++bj) {
            const int colh = u.pn * BM + bj * HALF;
            const float sc = (colh < 512 || (colh >= 768 && colh < 1280)) ? QSCALE : 1.f;
            if (colh < 640) {
                const int d0 = 16 * (wc & 1) + 4 * fq; const int cb = colh + 64 * (wc >> 1) + d0;
                float invf[4];
#pragma unroll
                for (int i = 0; i < 4; ++i) invf[i] = __builtin_amdgcn_exp2f(-(float)(d0 + i) * (13.287712379549449f / 32.f)) * 0.15915494309189535f;
#pragma unroll
                for (int ai = 0; ai < 2; ++ai)
#pragma unroll
                    for (int m = 0; m < 4; ++m) {
                        const float pos = (float)(16 + t0 + ai * HALF + m * 16);
                        const f32x4 v0 = acc[ai][bj][m][0], v1 = acc[ai][bj][m][1]; float lo[4], hi[4];
#pragma unroll
                        for (int i = 0; i < 4; ++i) { const float rev = __builtin_amdgcn_fractf(pos * invf[i]); const float s = __builtin_amdgcn_sinf(rev), c = __builtin_amdgcn_cosf(rev);
                            lo[i] = (v0[i] * c - v1[i] * s) * sc; hi[i] = (v1[i] * c + v0[i] * s) * sc; }
                        bf16_t* rp = obase + (size_t)(ai * HALF + m * 16) * PROJ_LD + cb;
                        u32x2 w0, w1; w0.x = cvt_pk_bf16(lo[0], lo[1]); w0.y = cvt_pk_bf16(lo[2], lo[3]); w1.x = cvt_pk_bf16(hi[0], hi[1]); w1.y = cvt_pk_bf16(hi[2], hi[3]);
                        *(u32x2*)rp = w0; *(u32x2*)(rp + 32) = w1;
                    }
            } else {
                const int col0 = colh + wc * 32 + 8 * fq;
#pragma unroll
                for (int ai = 0; ai < 2; ++ai)
#pragma unroll
                    for (int m = 0; m < 4; ++m) {
                        const f32x4 v0 = acc[ai][bj][m][0] * sc, v1 = acc[ai][bj][m][1] * sc;
                        u32x4 w; w.x = cvt_pk_bf16(v0[0], v0[1]); w.y = cvt_pk_bf16(v0[2], v0[3]); w.z = cvt_pk_bf16(v1[0], v1[1]); w.w = cvt_pk_bf16(v1[2], v1[3]);
                        *(u32x4*)(obase + (size_t)(ai * HALF + m * 16) * PROJ_LD + col0) = w;
                    }
            }
        }
    }
};
template <bool WBF> struct EpiRes {
    static constexpr bool PERM = false, AFTER_DRAIN = false;
    const float* base; float* out; bf16_t* xb; float* rowss;
    __device__ __forceinline__ void operator()(const f32x4 (&acc)[2][2][4][2], const Unit& u, int wr, int wc, int fr, int fq) const {
        const int row0 = u.pm * BM + wr * 64 + fr, col0 = u.pn * BM + wc * 32 + 4 * fq;
#pragma unroll
        for (int ai = 0; ai < 2; ++ai)
#pragma unroll
            for (int m = 0; m < 4; ++m) {
                const int row = row0 + ai * HALF + m * 16; const size_t off = (size_t)row * 1024 + col0; float ss = 0.f;
#pragma unroll
                for (int bj = 0; bj < 2; ++bj)
#pragma unroll
                    for (int n = 0; n < 2; ++n) {
                        const size_t o2 = off + bj * HALF + n * 16;
                        const f32x4 hv = *(const f32x4*)(base + o2) + acc[ai][bj][m][n];
                        *(f32x4*)(out + o2) = hv;
                        if (WBF) { u32x2 w; w.x = cvt_pk_bf16(hv[0], hv[1]); w.y = cvt_pk_bf16(hv[2], hv[3]); *(u32x2*)(xb + o2) = w; }
                        ss += (hv[0] * hv[0] + hv[1] * hv[1]) + (hv[2] * hv[2] + hv[3] * hv[3]);
                    }
                ss += __shfl_xor(ss, 16); ss += __shfl_xor(ss, 32);
                if (fq == 0) atomicAdd(rowss + row, ss);
                if (m & 1) asm volatile("" ::: "memory");
            }
    }
};
struct EpiSwiGLU {
    static constexpr bool PERM = true, AFTER_DRAIN = false;
    bf16_t* H; const float* rowss;
    __device__ __forceinline__ void operator()(const f32x4 (&acc)[2][2][4][2], const Unit& u, int wr, int wc, int fr, int fq) const {
        const int row0 = u.pm * BM + wr * 64 + fr, f0 = u.pn * 128 + wc * 16 + 4 * fq;
#pragma unroll
        for (int ai = 0; ai < 2; ++ai)
#pragma unroll
            for (int m = 0; m < 4; ++m) {
                const int row = row0 + ai * HALF + m * 16;
                const float r = __builtin_amdgcn_rsqf(rowss[row] * (1.f / 1024.f) + 1e-6f);
#pragma unroll
                for (int bj = 0; bj < 2; ++bj) {
                    const f32x4 g = acc[ai][bj][m][0] * r, up = acc[ai][bj][m][1] * r; float hv[4];
#pragma unroll
                    for (int i = 0; i < 4; ++i) hv[i] = g[i] * up[i] * __builtin_amdgcn_rcpf(1.f + __builtin_amdgcn_exp2f(-1.4426950408889634f * g[i]));
                    u32x2 w; w.x = cvt_pk_bf16(hv[0], hv[1]); w.y = cvt_pk_bf16(hv[2], hv[3]);
                    *(u32x2*)(H + (size_t)row * 2816 + f0 + bj * 64) = w;
                }
            }
    }
};

template <class Epi, class Sched, bool ALIGN_EPI = false, bool SP2 = false>
__device__ __forceinline__ void gemm_phase(PG8_LAS unsigned char* lds, const Gemm g, const Sched& S, const Epi& E) {
    const int tid = threadIdx.x, wid = __builtin_amdgcn_readfirstlane(tid >> 6), lane = tid & 63, wr = wid >> 2, wc = wid & 3, fr = lane & 15, fq = lane >> 4;
    const int K = g.K, nt = K / BK;
    unsigned voffA[2], voffB[2];
#pragma unroll
    for (int i = 0; i < 2; ++i) { int R, C; stage_rc(tid * 16 + i * 8192, R, C); const int Rb = Epi::PERM ? ((R & ~31) + perm32(R & 31)) : R;
        voffA[i] = (unsigned)(R * K + C) * 2u; voffB[i] = (unsigned)(Rb * K + C) * 2u; }
    const size_t kstep = (size_t)(BK * 2);
    const size_t hstep = (size_t)HALF * K * 2;
    const size_t tstep = 2 * hstep;
    const unsigned ldsw = (unsigned)wid * 1024u;
    const int aoff = lds_byte(wr * 64 + fr, fq * 8), boff = lds_byte(wc * 32 + fr, fq * 8);
#define PG8_SA(b, h) (((b) * 2 + (h)) * HTB)
#define PG8_SB(b, h) ((4 + (b) * 2 + (h)) * HTB)
#define PG8_STAGE(bufoff, gbase, voff) do { _Pragma("unroll") for (int _i = 0; _i < 2; ++_i) \
        __builtin_amdgcn_global_load_lds((const unsigned*)((const char*)(gbase) + (voff)[_i]), (PG8_LAS unsigned*)(lds + (bufoff) + ldsw + _i * 8192), 16, 0, 0); } while (0)
#define PG8_LDA(dst, b, h) do { _Pragma("unroll") for (int m = 0; m < 4; ++m) _Pragma("unroll") for (int k = 0; k < 2; ++k) dst[m][k] = *(const PG8_LAS bf16x8*)(lds + PG8_SA(b, h) + aoff + m * 2048 + k * 1024); } while (0)
#define PG8_LDB(dst, b, h) do { _Pragma("unroll") for (int n = 0; n < 2; ++n) _Pragma("unroll") for (int k = 0; k < 2; ++k) dst[n][k] = *(const PG8_LAS bf16x8*)(lds + PG8_SB(b, h) + boff + n * 2048 + k * 1024); } while (0)
#define PG8_MMA(ai, bj, At, Bt) do { __builtin_amdgcn_s_setprio(1); _Pragma("unroll") for (int m = 0; m < 4; ++m) _Pragma("unroll") for (int n = 0; n < 2; ++n) _Pragma("unroll") for (int k = 0; k < 2; ++k) \
        acc[ai][bj][m][n] = __builtin_amdgcn_mfma_f32_16x16x32_bf16(Bt[n][k], At[m][k], acc[ai][bj][m][n], 0, 0, 0); __builtin_amdgcn_s_setprio(0); } while (0)
#define PG8_WAIT_V(n) asm volatile("s_waitcnt vmcnt(" #n ")" ::: "memory")
#define PG8_WAIT_L(n) asm volatile("s_waitcnt lgkmcnt(" #n ")" ::: "memory")
#define PG8_BAR __builtin_amdgcn_s_barrier()
#define PG8_SCHED __builtin_amdgcn_sched_barrier(0)
    Unit cur, nxt; int ui = 0;
    if (!S.next(0, cur)) return;
    f32x4 acc[2][2][4][2];
#pragma unroll
    for (int a = 0; a < 2; ++a)
#pragma unroll
        for (int b = 0; b < 2; ++b)
#pragma unroll
            for (int m = 0; m < 4; ++m)
#pragma unroll
                for (int n = 0; n < 2; ++n) acc[a][b][m][n] = (f32x4){0.f, 0.f, 0.f, 0.f};
    bf16x8 At[4][2], B0[2][2], B1[2][2];
    const char* cA = (const char*)g.A + (size_t)cur.pm * tstep; const char* cB = (const char*)g.Bt + (size_t)cur.pn * tstep;
    S.a_ready(cur);
    if constexpr (SP2) {
        PG8_STAGE(PG8_SB(0, 0), cB, voffB); PG8_STAGE(PG8_SB(0, 1), cB + hstep, voffB); PG8_STAGE(PG8_SA(0, 0), cA, voffA); PG8_STAGE(PG8_SA(0, 1), cA + hstep, voffA);
        if (wr == 1) PG8_BAR;
        PG8_WAIT_V(2); PG8_BAR;
        PG8_STAGE(PG8_SB(1, 0), cB + kstep, voffB); PG8_STAGE(PG8_SA(1, 0), cA + kstep, voffA); PG8_STAGE(PG8_SB(1, 1), cB + hstep + kstep, voffB);
        PG8_WAIT_V(6); PG8_BAR;
    } else {
        PG8_STAGE(PG8_SB(0, 0), cB, voffB); PG8_STAGE(PG8_SA(0, 0), cA, voffA); PG8_STAGE(PG8_SB(0, 1), cB + hstep, voffB); PG8_STAGE(PG8_SA(0, 1), cA + hstep, voffA);
        if (wr == 1) PG8_BAR;
        PG8_WAIT_V(4); PG8_BAR;
        PG8_STAGE(PG8_SB(1, 0), cB + kstep, voffB); PG8_STAGE(PG8_SA(1, 0), cA + kstep, voffA); PG8_STAGE(PG8_SB(1, 1), cB + hstep + kstep, voffB);
        PG8_WAIT_V(6); PG8_BAR;
    }
    for (;;) {
        const bool has_next = S.next(ui + 1, nxt);
        const char* nA = has_next ? (const char*)g.A + (size_t)nxt.pm * tstep : cA; const char* nB = has_next ? (const char*)g.Bt + (size_t)nxt.pn * tstep : cB;
        for (int t = 0; t < nt; t += 2) {
            const bool last = (t == nt - 2);
            const char* a1 = cA + (size_t)(t + 1) * kstep;
            const char* a2 = last ? nA : cA + (size_t)(t + 2) * kstep; const char* b2 = last ? nB : cB + (size_t)(t + 2) * kstep;
            const char* a3 = a2 + kstep; const char* b3 = b2 + kstep;
            if (last && has_next) S.a_ready(nxt);
            if constexpr (SP2) {
            PG8_LDB(B0, 0, 0); PG8_LDB(B1, 0, 1); PG8_SCHED; PG8_LDA(At, 0, 0); PG8_STAGE(PG8_SA(1, 1), a1 + hstep, voffA);
            PG8_WAIT_V(8); PG8_WAIT_L(0); PG8_BAR; PG8_MMA(0, 0, At, B0); PG8_MMA(0, 1, At, B1); PG8_BAR; PG8_SCHED;
            PG8_LDA(At, 0, 1); PG8_STAGE(PG8_SB(0, 0), b2, voffB); PG8_STAGE(PG8_SB(0, 1), b2 + hstep, voffB); PG8_STAGE(PG8_SA(0, 0), a2, voffA);
            PG8_WAIT_V(8); PG8_WAIT_L(0); PG8_BAR; PG8_MMA(1, 0, At, B0); PG8_MMA(1, 1, At, B1); PG8_BAR; PG8_SCHED;
            PG8_LDB(B0, 1, 0); PG8_LDB(B1, 1, 1); PG8_SCHED; PG8_LDA(At, 1, 0); PG8_STAGE(PG8_SA(0, 1), a2 + hstep, voffA);
            PG8_WAIT_V(8); PG8_WAIT_L(0); PG8_BAR; PG8_MMA(0, 0, At, B0); PG8_MMA(0, 1, At, B1); PG8_BAR; PG8_SCHED;
            PG8_LDA(At, 1, 1); PG8_STAGE(PG8_SB(1, 0), b3, voffB); PG8_STAGE(PG8_SB(1, 1), b3 + hstep, voffB); PG8_STAGE(PG8_SA(1, 0), a3, voffA);
            PG8_WAIT_V(8); PG8_WAIT_L(0); PG8_BAR; PG8_MMA(1, 0, At, B0); PG8_MMA(1, 1, At, B1); PG8_BAR; PG8_SCHED;
            } else {
            PG8_LDB(B0, 0, 0); PG8_SCHED; PG8_LDA(At, 0, 0); PG8_STAGE(PG8_SA(1, 1), a1 + hstep, voffA);
            PG8_WAIT_L(8); PG8_BAR; PG8_WAIT_L(0); PG8_MMA(0, 0, At, B0); PG8_BAR; PG8_SCHED;
            PG8_LDB(B1, 0, 1); PG8_STAGE(PG8_SB(0, 0), b2, voffB);
            PG8_BAR; PG8_WAIT_L(0); PG8_MMA(0, 1, At, B1); PG8_BAR;
            PG8_LDA(At, 0, 1); PG8_STAGE(PG8_SA(0, 0), a2, voffA);
            PG8_BAR; PG8_WAIT_L(0); PG8_MMA(1, 0, At, B0); PG8_BAR; PG8_SCHED;
            PG8_STAGE(PG8_SB(0, 1), b2 + hstep, voffB);
            PG8_WAIT_V(6); PG8_BAR; PG8_MMA(1, 1, At, B1); PG8_BAR;
            PG8_LDB(B0, 1, 0); PG8_SCHED; PG8_LDA(At, 1, 0); PG8_STAGE(PG8_SA(0, 1), a2 + hstep, voffA);
            PG8_WAIT_L(8); PG8_BAR; PG8_WAIT_L(0); PG8_MMA(0, 0, At, B0); PG8_BAR; PG8_SCHED;
            PG8_LDB(B1, 1, 1); PG8_STAGE(PG8_SB(1, 0), b3, voffB);
            PG8_BAR; PG8_WAIT_L(0); PG8_MMA(0, 1, At, B1); PG8_BAR;
            PG8_LDA(At, 1, 1); PG8_STAGE(PG8_SA(1, 0), a3, voffA);
            PG8_BAR; PG8_WAIT_L(0); PG8_MMA(1, 0, At, B0); PG8_BAR; PG8_SCHED;
            PG8_STAGE(PG8_SB(1, 1), b3 + hstep, voffB);
            PG8_WAIT_V(6); PG8_BAR; PG8_MMA(1, 1, At, B1); PG8_BAR;
            }
        }
        if constexpr (ALIGN_EPI) { if (wr == 0) PG8_BAR; }
        if constexpr (!Epi::AFTER_DRAIN) { E(acc, cur, wr, wc, fr, fq); S.done(cur); }
        if (!has_next) break;
#pragma unroll
        for (int a = 0; a < 2; ++a)
#pragma unroll
            for (int b = 0; b < 2; ++b)
#pragma unroll
                for (int m = 0; m < 4; ++m)
#pragma unroll
                    for (int n = 0; n < 2; ++n) acc[a][b][m][n] = (f32x4){0.f, 0.f, 0.f, 0.f};
        cur = nxt; cA = nA; cB = nB; ++ui;
        if constexpr (ALIGN_EPI) { if (wr == 1) PG8_BAR; }
    }
    PG8_WAIT_V(0);
    if constexpr (!ALIGN_EPI) { if (wr == 0) PG8_BAR; }
    PG8_BAR;
    if constexpr (Epi::AFTER_DRAIN) { E.fused(acc, cur, wr, wc, fr, fq, lds, wid, lane); S.done(cur); }
#undef PG8_SA
#undef PG8_SB
#undef PG8_STAGE
#undef PG8_LDA
#undef PG8_LDB
#undef PG8_MMA
#undef PG8_WAIT_V
#undef PG8_WAIT_L
#undef PG8_BAR
#undef PG8_SCHED
}
}

typedef unsigned short bf16;
typedef float f32x4 __attribute__((ext_vector_type(4)));
typedef float f32x16 __attribute__((ext_vector_type(16)));
typedef short bf16x8 __attribute__((ext_vector_type(8)));
typedef short s16x4 __attribute__((ext_vector_type(4)));
typedef unsigned u32x4 __attribute__((ext_vector_type(4)));
typedef unsigned u32x2 __attribute__((ext_vector_type(2)));
#define LAS __attribute__((address_space(3)))
#define LDS_WAIT() asm volatile("s_waitcnt lgkmcnt(0)" ::: "memory")

constexpr int BATCH = 32, SEQ = 2048, D = 1024, PR = 2176, M = BATCH * SEQ, NIN = 2304, DFF = 2816, NGU = 2 * DFF, PLD = 2304;
constexpr float EPS = 1e-6f;
constexpr size_t MiB = 1u << 20;
constexpr size_t WS_CTL = 0, CTL_ZERO_BYTES = 1 * MiB, WS_SS1 = 256 * 1024, WS_SS2 = 512 * 1024;
constexpr size_t WS_WIN = 2 * MiB, WS_WOUT = 7 * MiB, WS_WGU = 9 * MiB, WS_WDN = 20 * MiB;
constexpr size_t WS_XN = 32 * MiB, WS_PROJ = 160 * MiB, WS_AO = 466 * MiB, WS_H = 160 * MiB, WS_END = 594 * MiB;
static_assert(WS_WIN + (size_t)NIN * D * 2 <= WS_WOUT && WS_WOUT + (size_t)D * D * 2 <= WS_WGU && WS_WGU + (size_t)NGU * D * 2 <= WS_WDN && WS_WDN + (size_t)D * DFF * 2 <= WS_XN, "weights map");
static_assert(WS_XN + (size_t)M * D * 2 <= WS_PROJ && WS_PROJ + (size_t)BATCH * PR * PLD * 2 <= WS_AO && WS_AO + (size_t)M * D * 2 <= WS_END && WS_H + (size_t)M * DFF * 2 <= WS_END, "activation map");
constexpr int NWAVES = 8;
constexpr int RING_BYTES = 131072, LDS_BYTES = 147456;

__device__ __forceinline__ unsigned f2bf(float f) { unsigned u = __builtin_bit_cast(unsigned, f); return (u + 0x7fffu + ((u >> 16) & 1u)) >> 16; }
__device__ __forceinline__ unsigned pk2(float lo, float hi) { return f2bf(lo) | (f2bf(hi) << 16); }
__device__ __forceinline__ float bf2f(unsigned short b) { return __builtin_bit_cast(float, (unsigned)b << 16); }
__device__ __forceinline__ float wave_sum(float v) {
#pragma unroll
    for (int o = 1; o < 64; o <<= 1) v += __shfl_xor(v, o);
    return v;
}

namespace att {
constexpr int L_K = 0, L_V = 16384, L_WS = 32768, L_OST = L_WS + NWAVES * 256, L_FLAG = L_OST + NWAVES * 4096, L_END = L_FLAG + 64;
static_assert(L_END <= RING_BYTES, "attention LDS");
__device__ __forceinline__ int crow(int r, int hi) { return (r & 3) + 8 * (r >> 2) + 4 * hi; }
__device__ __forceinline__ unsigned cvtpk(float lo, float hi) { unsigned r; asm("v_cvt_pk_bf16_f32 %0, %1, %2" : "=v"(r) : "v"(lo), "v"(hi)); return r; }
typedef LAS const char* lds_cptr;
typedef short v4i16_t __attribute__((ext_vector_type(4)));
__device__ __forceinline__ s16x4 vtr(lds_cptr p) { return __builtin_bit_cast(s16x4, __builtin_amdgcn_ds_read_tr16_b64_v4i16((LAS v4i16_t*)p)); }
#define MFMA32(a, b, c) __builtin_amdgcn_mfma_f32_32x32x16_bf16(a, b, c, 0, 0, 0)
__device__ __forceinline__ float swap_sum(float v) { auto rr = __builtin_amdgcn_permlane32_swap(__float_as_uint(v), __float_as_uint(v), false, false); return __uint_as_float(rr[0]) + __uint_as_float(rr[1]); }

template <int MODE>
__device__ __forceinline__ void attn_unit(int b, int h, int qb, const bf16* __restrict__ PROJ, bf16* AO, const float* sinks, LAS char* shm) {
    const int tid = threadIdx.x, lane = tid & 63, r32 = lane & 31, hi = lane >> 5; const int wid = __builtin_amdgcn_readfirstlane(tid >> 6);
    const size_t rowbase = (size_t)b * PR; const int p0 = 128 + 256 * qb;
    const int qcol = MODE == 0 ? h * 64 : 768 + h * 64, kcol = MODE == 0 ? 512 + (h >> 2) * 64 : 1280 + h * 64, vcol = MODE == 0 ? 640 + (h >> 2) * 64 : 1792 + h * 64;
    const bf16* Qw = PROJ + (rowbase + p0 + wid * 32) * PLD + qcol;
    bf16x8 qr[4];
#pragma unroll
    for (int d0 = 0; d0 < 4; ++d0) qr[d0] = *reinterpret_cast<const bf16x8*>(Qw + (size_t)r32 * PLD + d0 * 16 + hi * 8);
    const bf16* ksrc = PROJ + (rowbase + lane) * PLD + kcol + wid * 8;
    const bf16* vsrc = PROJ + (rowbase + 16 * (wid & 3) + (lane >> 2)) * PLD + vcol + (wid >> 2) * 32 + (lane & 3) * 8;
    const lds_cptr kp0 = (lds_cptr)shm + L_K + hi * 1024 + r32 * 16;
    const lds_cptr vp0 = (lds_cptr)shm + L_V + ((lane >> 4) & 1) * 32 + (lane & 3) * 8 + (4 * hi + ((lane & 15) >> 2)) * 64;
    LAS float* wsf = (LAS float*)(shm + L_WS) + wid * 64;
    volatile LAS unsigned* flags = (volatile LAS unsigned*)(shm + L_FLAG);
    const int jhi = 4 * qb + 5;
    const int NT = MODE == 1 ? jhi : (qb == 0 ? 5 : 7);
    const int jw = 2 + 4 * qb + (wid >> 1);
#define TILE_OF(it) ((MODE == 1 || (it) < (qb == 0 ? 5 : 6)) ? jhi - (it) : 1)
    f32x16 o[2]; o[0] = f32x16{}; o[1] = f32x16{};
    float mrun = 0.f, lrun = 0.f, carry = 1.f; bool wdone = false;
    if (MODE == 0) { mrun = sinks[h] * 1.4426950408889634f; lrun = hi == 0 ? 1.f : 0.f; }
    const int prow = p0 + wid * 32 + r32;
    { const int j = TILE_OF(0); const u32x4 kr = *(const u32x4*)(ksrc + (size_t)j * 64 * PLD), vr = *(const u32x4*)(vsrc + (size_t)j * 64 * PLD);
      *(LAS u32x4*)(shm + L_K + tid * 16) = kr; *(LAS u32x4*)(shm + L_V + tid * 16) = vr; }
    __syncthreads();
    int cur = 0;
    for (int it = 0; it < NT; ++it) {
        const int j = TILE_OF(it);
        const bool has_next = it + 1 < NT;
        u32x4 kr, vr;
        if (has_next) { const int jn = TILE_OF(it + 1); kr = *(const u32x4*)(ksrc + (size_t)jn * 64 * PLD); vr = *(const u32x4*)(vsrc + (size_t)jn * 64 * PLD); }
        bool active;
        if (MODE == 1) active = (j <= jw) && !wdone; else active = (j == 1) || (j >= jw - 2 && j <= jw);
        if (active) {
            const lds_cptr kp = kp0 + cur * 8192; const lds_cptr vp = vp0 + cur * 8192;
            f32x16 s0 = f32x16{}, s1 = f32x16{};
#pragma unroll
            for (int d0 = 0; d0 < 4; ++d0) {
                const bf16x8 k0 = *(const LAS bf16x8*)(kp + d0 * 2048), k1 = *(const LAS bf16x8*)(kp + d0 * 2048 + 512);
                s0 = MFMA32(k0, qr[d0], s0); s1 = MFMA32(k1, qr[d0], s1);
            }
            const int qrel = prow - 64 * j;
            u32x4 pw[4];
            if (MODE == 0) {
                if (j == 1) {
#pragma unroll
                    for (int r = 0; r < 16; ++r) { const int kk = crow(r, hi); if (kk < 48) s0[r] = -INFINITY; if (kk + 32 < 48) s1[r] = -INFINITY; }
                } else {
#pragma unroll
                    for (int r = 0; r < 16; ++r) { const int kk = crow(r, hi); if (kk > qrel || kk < qrel - 127) s0[r] = -INFINITY; if (kk + 32 > qrel || kk + 32 < qrel - 127) s1[r] = -INFINITY; }
                }
                float rm = s0[0];
#pragma unroll
                for (int r = 1; r < 16; ++r) rm = fmaxf(rm, s0[r]);
#pragma unroll
                for (int r = 0; r < 16; ++r) rm = fmaxf(rm, s1[r]);
                { auto rr = __builtin_amdgcn_permlane32_swap(__float_as_uint(rm), __float_as_uint(rm), false, false); rm = fmaxf(__uint_as_float(rr[0]), __uint_as_float(rr[1])); }
                const float mnew = fmaxf(mrun, rm);
                const bool grow = mnew > mrun;
                if (__any(grow)) {
                    const float alpha = __builtin_amdgcn_exp2f(mrun - mnew); lrun *= alpha;
                    if (hi == 0) wsf[r32] = alpha;
                    LDS_WAIT();
#pragma unroll
                    for (int r = 0; r < 16; ++r) { const float a = wsf[crow(r, hi)]; o[0][r] *= a; o[1][r] *= a; }
                    LDS_WAIT();
                }
                mrun = mnew; float sacc = 0.f;
#pragma unroll
                for (int r = 0; r < 16; ++r) { s0[r] = __builtin_amdgcn_exp2f(s0[r] - mnew); s1[r] = __builtin_amdgcn_exp2f(s1[r] - mnew); sacc += s0[r] + s1[r]; }
                lrun += sacc;
            } else {
                const bool diag = (j == jw);
#pragma unroll
                for (int r = 0; r < 16; ++r) {
                    const int kk = crow(r, hi);
                    float e0 = __builtin_amdgcn_exp2f(fminf(s0[r], 30.f)), e1 = __builtin_amdgcn_exp2f(fminf(s1[r], 30.f));
                    if (diag) { if (kk >= qrel) e0 = 0.f; if (kk + 32 >= qrel) e1 = 0.f; }
                    if (j == 1) { if (kk < 48) e0 = 0.f; if (kk + 32 < 48) e1 = 0.f; }
                    s0[r] = e0; s1[r] = e1;
                }
                float sp0[16], sp1[16], tot[8];
#pragma unroll
                for (int g = 0; g < 4; ++g) {
                    sp0[4 * g + 3] = 1.f + s0[4 * g + 3]; sp1[4 * g + 3] = 1.f + s1[4 * g + 3];
#pragma unroll
                    for (int i = 2; i >= 0; --i) { sp0[4 * g + i] = (1.f + s0[4 * g + i]) * sp0[4 * g + i + 1]; sp1[4 * g + i] = (1.f + s1[4 * g + i]) * sp1[4 * g + i + 1]; }
                    tot[g] = sp0[4 * g]; tot[4 + g] = sp1[4 * g];
                }
                float E[8]; float S = carry;
#pragma unroll
                for (int gi = 7; gi >= 0; --gi) {
                    auto rr = __builtin_amdgcn_permlane32_swap(__float_as_uint(tot[gi]), __float_as_uint(tot[gi]), false, false);
                    const float A = __uint_as_float(rr[0]), B = __uint_as_float(rr[1]);
                    E[gi] = hi ? S : S * B;
                    S = S * (A * B);
                }
                carry = S;
#pragma unroll
                for (int g = 0; g < 4; ++g)
#pragma unroll
                    for (int i = 0; i < 4; ++i) {
                        s0[4 * g + i] = s0[4 * g + i] * __builtin_amdgcn_rcpf(sp0[4 * g + i] * E[g]);
                        s1[4 * g + i] = s1[4 * g + i] * __builtin_amdgcn_rcpf(sp1[4 * g + i] * E[4 + g]);
                    }
                wdone = __all(carry > 1.8446744e19f);
            }
            pw[0] = (u32x4){cvtpk(s0[0], s0[1]), cvtpk(s0[2], s0[3]), cvtpk(s0[4], s0[5]), cvtpk(s0[6], s0[7])};
            pw[1] = (u32x4){cvtpk(s0[8], s0[9]), cvtpk(s0[10], s0[11]), cvtpk(s0[12], s0[13]), cvtpk(s0[14], s0[15])};
            pw[2] = (u32x4){cvtpk(s1[0], s1[1]), cvtpk(s1[2], s1[3]), cvtpk(s1[4], s1[5]), cvtpk(s1[6], s1[7])};
            pw[3] = (u32x4){cvtpk(s1[8], s1[9]), cvtpk(s1[10], s1[11]), cvtpk(s1[12], s1[13]), cvtpk(s1[14], s1[15])};
#pragma unroll
            for (int dh = 0; dh < 2; ++dh)
#pragma unroll
                for (int kk = 0; kk < 4; ++kk) {
                    const s16x4 lo = vtr(vp + dh * 4096 + kk * 1024), up = vtr(vp + dh * 4096 + kk * 1024 + 512);
                    const bf16x8 vf = (bf16x8){lo[0], lo[1], lo[2], lo[3], up[0], up[1], up[2], up[3]};
                    o[dh] = MFMA32(__builtin_bit_cast(bf16x8, pw[kk]), vf, o[dh]);
                }
        }
        if (has_next) { *(LAS u32x4*)(shm + L_K + (cur ^ 1) * 8192 + tid * 16) = kr; *(LAS u32x4*)(shm + L_V + (cur ^ 1) * 8192 + tid * 16) = vr; }
        if (MODE == 1) { if (lane == 0) flags[(it & 1) * 8 + wid] = wdone ? 1u : 0u; }
        __syncthreads();
        cur ^= 1;
        if (MODE == 1) {
            unsigned alld = 1u;
#pragma unroll
            for (int w = 0; w < 8; ++w) alld &= flags[(it & 1) * 8 + w];
            if (alld) break;
        }
    }
#undef TILE_OF
    float rli[16];
    if (MODE == 0) {
        const float lt = swap_sum(lrun);
        if (hi == 0) wsf[32 + r32] = lt; LDS_WAIT();
#pragma unroll
        for (int r = 0; r < 16; ++r) rli[r] = __builtin_amdgcn_rcpf(wsf[32 + crow(r, hi)]);
    } else {
#pragma unroll
        for (int r = 0; r < 16; ++r) rli[r] = 1.f;
    }
    LAS bf16* stg = (LAS bf16*)(shm + L_OST) + wid * 2048;
#pragma unroll
    for (int r = 0; r < 16; ++r) { const int orow = crow(r, hi);
#pragma unroll
        for (int dh = 0; dh < 2; ++dh) stg[orow * 64 + dh * 32 + r32] = (bf16)f2bf(o[dh][r] * rli[r]); }
    LDS_WAIT();
    bf16* Ow = AO + ((size_t)b * SEQ + 256 * qb + wid * 32) * D + (MODE == 0 ? 0 : 512) + h * 64;
#pragma unroll
    for (int i = 0; i < 4; ++i) { const int row = i * 8 + (lane >> 3), ch = lane & 7; *(u32x4*)(Ow + (size_t)row * D + ch * 8) = *(const LAS u32x4*)(stg + row * 64 + ch * 8); }
    LDS_WAIT();
    __syncthreads();
}
}

template <int MAP> __device__ __forceinline__ int rowmap(int c) {
    if (MAP == 1) { if (c >= 640) return c; const int d = c & 63, n = d >> 5, rem = d & 31; return (c & ~63) + 32 * (rem >> 4) + 8 * ((rem >> 2) & 3) + 4 * n + (rem & 3); }
    if (MAP == 2) return 8 * (c >> 2) + (c & 3);
    if (MAP == 3) return 8 * (c >> 2) + 4 + (c & 3);
    return c;
}
template <int MAP> __device__ __forceinline__ void transpose_item(const float* __restrict__ W, int K, int N, bf16* WT, const float* gain, LAS float* scr, int item, int lane) {
    const int nblk = N / 32, kb = item / nblk, nb = item % nblk, k0 = 64 * kb, n0 = 32 * nb;
#pragma unroll 8
    for (int i = 0; i < 32; ++i) { const int kk = 2 * i + (lane >> 5); scr[kk * 33 + (lane & 31)] = W[(size_t)(k0 + kk) * N + n0 + (lane & 31)]; }
    LDS_WAIT(); asm volatile("" ::: "memory");
    const int c = lane & 7;
    float gv[8];
#pragma unroll
    for (int e = 0; e < 8; ++e) gv[e] = gain ? gain[k0 + 8 * c + e] : 1.f;
#pragma unroll
    for (int j = 0; j < 4; ++j) { const int n = (lane >> 3) + 8 * j; const LAS float* s = scr + (8 * c) * 33 + n;
        u32x4 o; o.x = pk2(s[0 * 33] * gv[0], s[1 * 33] * gv[1]); o.y = pk2(s[2 * 33] * gv[2], s[3 * 33] * gv[3]); o.z = pk2(s[4 * 33] * gv[4], s[5 * 33] * gv[5]); o.w = pk2(s[6 * 33] * gv[6], s[7 * 33] * gv[7]);
        *(u32x4*)(WT + (size_t)rowmap<MAP>(n0 + n) * K + k0 + 8 * c) = o; }
    LDS_WAIT(); asm volatile("" ::: "memory");
}
__device__ __forceinline__ void rms_row_to_bf16(const float* xrow, const float* gain, bf16* orow, int lane) {
    const f32x4* xr = (const f32x4*)xrow + lane; const f32x4* gr = (const f32x4*)gain + lane;
    f32x4 v[4]; float s = 0.f;
#pragma unroll
    for (int j = 0; j < 4; ++j) { v[j] = xr[64 * j]; s += (v[j].x * v[j].x + v[j].y * v[j].y) + (v[j].z * v[j].z + v[j].w * v[j].w); }
    const float rstd = 1.f / sqrtf(wave_sum(s) * (1.f / D) + EPS);
    unsigned long long* o8 = (unsigned long long*)orow + lane;
#pragma unroll
    for (int j = 0; j < 4; ++j) { const f32x4 g = gr[64 * j]; o8[64 * j] = (unsigned long long)pk2(v[j].x * rstd * g.x, v[j].y * rstd * g.y) | ((unsigned long long)pk2(v[j].z * rstd * g.z, v[j].w * rstd * g.w) << 32); }
}
__device__ __forceinline__ void meta_unit(int u, const float* meta, const float* gmix, const float* __restrict__ Win, bf16* PROJ, LAS float* scr, int lane) {
    const int cgp = u % 20, rg = u / 20; const int c0 = cgp < 4 ? 512 + 64 * cgp : 1280 + 64 * (cgp - 4);
#pragma unroll
    for (int r = 0; r < 4; ++r) {
        const f32x4* xr = (const f32x4*)(meta + (size_t)(4 * rg + r) * D) + lane; const f32x4* gr = (const f32x4*)gmix + lane;
        f32x4 v[4]; float s = 0.f;
#pragma unroll
        for (int j = 0; j < 4; ++j) { v[j] = xr[64 * j]; s += (v[j].x * v[j].x + v[j].y * v[j].y) + (v[j].z * v[j].z + v[j].w * v[j].w); }
        const float rstd = 1.f / sqrtf(wave_sum(s) * (1.f / D) + EPS);
#pragma unroll
        for (int j = 0; j < 4; ++j) { const f32x4 g = gr[64 * j]; *(LAS f32x4*)(scr + r * 1024 + 4 * (lane + 64 * j)) = v[j] * rstd * g; }
    }
    LDS_WAIT(); asm volatile("" ::: "memory");
    float acc[4] = {0.f, 0.f, 0.f, 0.f};
    const float* wp = Win + c0 + lane;
#pragma unroll 8
    for (int k = 0; k < D; ++k) { const float w = wp[(size_t)k * NIN];
#pragma unroll
        for (int r = 0; r < 4; ++r) acc[r] += scr[r * 1024 + k] * w; }
    if (cgp < 2) {
        const int d = lane & 31; const float invf = __builtin_amdgcn_exp2f(-(float)d * (13.287712379549449f / 32.f)) * 0.15915494309189535f;
#pragma unroll
        for (int r = 0; r < 4; ++r) { const float other = __shfl_xor(acc[r], 32); const float rev = __builtin_amdgcn_fractf((float)(4 * rg + r) * invf);
            const float s = __builtin_amdgcn_sinf(rev), c = __builtin_amdgcn_cosf(rev); acc[r] = lane < 32 ? acc[r] * c - other * s : acc[r] * c + other * s; }
    }
    for (int b = 0; b < BATCH; ++b)
#pragma unroll
        for (int r = 0; r < 4; ++r) PROJ[((size_t)b * PR + 112 + 4 * rg + r) * PLD + c0 + lane] = (bf16)f2bf(acc[r]);
    LDS_WAIT(); asm volatile("" ::: "memory");
}

struct Args { const float* in[13]; float* out; unsigned char* ws; int ph_lo, ph_hi; };
constexpr int N_PHASES = 8;
__global__ void __launch_bounds__(NWAVES * 64, 2) hymba_fwd(Args args) {
    extern __shared__ __attribute__((aligned(16))) unsigned char lds_raw[];
    LAS unsigned char* lds = (LAS unsigned char*)lds_raw;
    const int tid = threadIdx.x, lane = tid & 63, wave = __builtin_amdgcn_readfirstlane(tid >> 6);
    const int G = gridDim.x, bx = blockIdx.x;
    const int vcu = (G % 8 == 0) ? (bx % 8) * (G / 8) + bx / 8 : bx;
    const int gw = vcu * NWAVES + wave, NGW = G * NWAVES;
    unsigned char* ws = args.ws;
    const float* x = args.in[0]; const float* meta = args.in[1]; const float* g_mix = args.in[2]; const float* w_in = args.in[3]; const float* sinks = args.in[4];
    const float* g_a = args.in[5]; const float* g_b = args.in[6]; const float* w_out = args.in[7]; const float* g_ffn = args.in[8];
    const float* w_gate = args.in[9]; const float* w_up = args.in[10]; const float* w_down = args.in[11]; const float* g_fin = args.in[12];
    float* out = args.out;
    bf16* Win_t = (bf16*)(ws + WS_WIN); bf16* Wout_t = (bf16*)(ws + WS_WOUT); bf16* Wgu_t = (bf16*)(ws + WS_WGU); bf16* Wdn_t = (bf16*)(ws + WS_WDN);
    bf16* XN = (bf16*)(ws + WS_XN); bf16* PROJ = (bf16*)(ws + WS_PROJ); bf16* AO = (bf16*)(ws + WS_AO); bf16* HB = (bf16*)(ws + WS_H);
    float* ss1 = (float*)(ws + WS_SS1); float* ss2 = (float*)(ws + WS_SS2);
    const int lo = args.ph_lo, hi = args.ph_hi;
#define IN(k) (lo <= (k) && (k) < hi)
#define SEAM(k) do { if (IN(k) && IN((k) + 1)) { cg::this_grid().sync(); } } while (0)

    if (IN(0)) {
        LAS float* scr = (LAS float*)(lds + wave * 16384);
        if (wave == 0 && bx < 80) meta_unit(bx, meta, g_mix, w_in, PROJ, scr, lane);
        constexpr int I_IN = (D / 64) * (NIN / 32), I_OUT = (D / 64) * (D / 32), I_G = (D / 64) * (DFF / 32), I_DN = (DFF / 64) * (D / 32);
        constexpr int NITEMS = I_IN + I_OUT + 2 * I_G + I_DN;
        for (int it = gw; it < NITEMS; it += NGW) {
            int r = it;
            if (r < I_IN) { transpose_item<1>(w_in, D, NIN, Win_t, nullptr, scr, r, lane); continue; } r -= I_IN;
            if (r < I_OUT) { transpose_item<0>(w_out, D, D, Wout_t, nullptr, scr, r, lane); continue; } r -= I_OUT;
            if (r < I_G) { transpose_item<2>(w_gate, D, DFF, Wgu_t, g_ffn, scr, r, lane); continue; } r -= I_G;
            if (r < I_G) { transpose_item<3>(w_up, D, DFF, Wgu_t, g_ffn, scr, r, lane); continue; } r -= I_G;
            transpose_item<0>(w_down, DFF, D, Wdn_t, nullptr, scr, r, lane);
        }
        for (int rr = gw; rr < BATCH * 48; rr += NGW) { bf16* rp = PROJ + ((size_t)(rr / 48) * PR + 64 + (rr % 48)) * PLD;
            for (int c = lane; c < PLD / 8; c += 64) *(u32x4*)(rp + c * 8) = (u32x4){0u, 0u, 0u, 0u}; }
        for (int m = gw; m < M; m += NGW) rms_row_to_bf16(x + (size_t)m * D, g_mix, XN + (size_t)m * D, lane);
    }
    SEAM(0);
    if (IN(1)) {
        pg8::Gemm g{XN, Win_t, M, NIN, D}; pg8::StaticOrder S; S.init(M, NIN, G, bx);
        pg8::EpiProj E{PROJ};
        pg8::gemm_phase<pg8::EpiProj, pg8::StaticOrder, true, true>(lds, g, S, E);
    }
    SEAM(1);
    if (IN(2)) {
        constexpr int NU = 2 * BATCH * 8 * 8;
        for (int u = vcu; u < NU; u += G) {
            const int grp = (u >> 8) & 1, v = (u & 255) + ((u >> 9) << 8); const int qb = v & 7, h = (v >> 3) & 7, b = v >> 6;
            if (grp == 0) att::attn_unit<0>(b, h, qb, PROJ, AO, sinks, (LAS char*)lds);
            else att::attn_unit<1>(b, h, qb, PROJ, AO, sinks, (LAS char*)lds);
        }
    }
    SEAM(2);
    if (IN(3)) {
        for (int m = gw; m < M; m += NGW) {
            u32x4* rp = (u32x4*)(AO + (size_t)m * D);
            u32x4 va = rp[lane], vb = rp[64 + lane]; float fa[8], fb[8]; float sa = 0.f, sb = 0.f;
#pragma unroll
            for (int e = 0; e < 4; ++e) { fa[2 * e] = __builtin_bit_cast(float, va[e] << 16); fa[2 * e + 1] = __builtin_bit_cast(float, va[e] & 0xffff0000u);
                fb[2 * e] = __builtin_bit_cast(float, vb[e] << 16); fb[2 * e + 1] = __builtin_bit_cast(float, vb[e] & 0xffff0000u); }
#pragma unroll
            for (int e = 0; e < 8; ++e) { sa += fa[e] * fa[e]; sb += fb[e] * fb[e]; }
            const float ra = 1.f / sqrtf(wave_sum(sa) * (1.f / 512.f) + EPS), rb = 1.f / sqrtf(wave_sum(sb) * (1.f / 512.f) + EPS);
            const f32x4 ga0 = ((const f32x4*)g_a)[2 * lane], ga1 = ((const f32x4*)g_a)[2 * lane + 1], gb0 = ((const f32x4*)g_b)[2 * lane], gb1 = ((const f32x4*)g_b)[2 * lane + 1];
            u32x4 oa, ob;
            oa.x = pk2(fa[0] * ra * ga0.x, fa[1] * ra * ga0.y); oa.y = pk2(fa[2] * ra * ga0.z, fa[3] * ra * ga0.w); oa.z = pk2(fa[4] * ra * ga1.x, fa[5] * ra * ga1.y); oa.w = pk2(fa[6] * ra * ga1.z, fa[7] * ra * ga1.w);
            ob.x = pk2(fb[0] * rb * gb0.x, fb[1] * rb * gb0.y); ob.y = pk2(fb[2] * rb * gb0.z, fb[3] * rb * gb0.w); ob.z = pk2(fb[4] * rb * gb1.x, fb[5] * rb * gb1.y); ob.w = pk2(fb[6] * rb * gb1.z, fb[7] * rb * gb1.w);
            rp[lane] = oa; rp[64 + lane] = ob;
        }
    }
    SEAM(3);
    if (IN(4)) {
        pg8::Gemm g{AO, Wout_t, M, D, D}; pg8::StaticOrder S; S.init(M, D, G, bx);
        pg8::EpiRes<true> E{x, out, XN, ss1};
        pg8::gemm_phase<pg8::EpiRes<true>, pg8::StaticOrder, true, true>(lds, g, S, E);
    }
    SEAM(4);
    if (IN(5)) {
        pg8::Gemm g{XN, Wgu_t, M, NGU, D}; pg8::StaticOrder S; S.init(M, NGU, G, bx);
        pg8::EpiSwiGLU E{HB, ss1};
        pg8::gemm_phase<pg8::EpiSwiGLU, pg8::StaticOrder, true, true>(lds, g, S, E);
    }
    SEAM(5);
    if (IN(6)) {
        pg8::Gemm g{HB, Wdn_t, M, D, DFF}; pg8::StaticOrder S; S.init(M, D, G, bx);
        pg8::EpiRes<false> E{out, out, nullptr, ss2};
        pg8::gemm_phase<pg8::EpiRes<false>, pg8::StaticOrder, true, true>(lds, g, S, E);
    }
    SEAM(6);
    if (IN(7)) {
        for (int m = gw; m < M; m += NGW) {
            const float r = 1.f / sqrtf(ss2[m] * (1.f / D) + EPS);
            f32x4* rp = (f32x4*)(out + (size_t)m * D) + lane; const f32x4* gr = (const f32x4*)g_fin + lane;
#pragma unroll
            for (int j = 0; j < 4; ++j) rp[64 * j] = rp[64 * j] * r * gr[64 * j];
        }
    }
#undef IN
#undef SEAM
}

#ifndef MK_N_LAUNCHES
#define MK_N_LAUNCHES 1
#endif
extern "C" void kernel_launch(void* const* d_in, const int* in_sizes, int n_in, void* d_out, int out_size, void* d_ws, size_t ws_size, hipStream_t stream) {
    static int grid = 0;
    if (grid == 0) {
        if (n_in != 13 || in_sizes[0] != M * D || out_size != M * D || ws_size < WS_END) { fprintf(stderr, "kernel_launch: unexpected shapes (n_in %d, in0 %d, out %d, ws %zu)\n", n_in, n_in > 0 ? in_sizes[0] : -1, out_size, ws_size); grid = -1; return; }
        int dev = 0, cus = 0, per_cu = 0;
        hipGetDevice(&dev); hipDeviceGetAttribute(&cus, hipDeviceAttributeMultiprocessorCount, dev);
        if (hipFuncSetAttribute((const void*)hymba_fwd, hipFuncAttributeMaxDynamicSharedMemorySize, LDS_BYTES) != hipSuccess) { fprintf(stderr, "kernel_launch: hipFuncSetAttribute failed\n"); grid = -1; return; }
        hipOccupancyMaxActiveBlocksPerMultiprocessor(&per_cu, (const void*)hymba_fwd, NWAVES * 64, LDS_BYTES);
        (void)hipGetLastError();
        if (per_cu < 1) per_cu = 1;
        grid = cus;
        fprintf(stderr, "kernel_launch: cus %d, occupancy %d blocks/CU, grid %d\n", cus, per_cu, grid);
    }
    if (grid < 0) return;
    hipMemsetAsync((char*)d_ws + WS_CTL, 0, CTL_ZERO_BYTES, stream);
    Args a{};
    for (int i = 0; i < 13; ++i) a.in[i] = (const float*)d_in[i];
    a.out = (float*)d_out; a.ws = (unsigned char*)d_ws;
    if (MK_N_LAUNCHES == 1) {
        a.ph_lo = 0; a.ph_hi = N_PHASES;
        void* kargs[] = {&a};
        hipError_t e = hipLaunchCooperativeKernel((const void*)hymba_fwd, dim3(grid), dim3(NWAVES * 64), kargs, LDS_BYTES, stream);
        if (e != hipSuccess) fprintf(stderr, "kernel_launch: cooperative launch failed: %s (grid %d)\n", hipGetErrorString(e), grid);
    } else {
        for (int p = 0; p < N_PHASES; ++p) { a.ph_lo = p; a.ph_hi = p + 1; hipLaunchKernelGGL(hymba_fwd, dim3(grid), dim3(NWAVES * 64), LDS_BYTES, stream, a); }
    }
}
```
